# Optimizing an MI355X kernel written in HIP

```python
import jax, jax.numpy as jnp
from jax import lax
import numpy as np

D_MODEL = 1024
BATCH = 2
SEQ = 8192
DEPTH = 1

MIX_WIDTH = D_MODEL
POOL_WIDTH = MIX_WIDTH // 2
CONV_WIDTH = MIX_WIDTH - POOL_WIDTH
POOL_WINDOWS = (2, 4, 8, 16)
N_POOL_GROUPS = len(POOL_WINDOWS)
POOL_GROUP_DIM = POOL_WIDTH // N_POOL_GROUPS
CONV_HEAD_DIM = 64
N_CONV_HEADS = CONV_WIDTH // CONV_HEAD_DIM
CONV_K = 3
IN_COLS = POOL_WIDTH + 3 * CONV_WIDTH
D_FF = ((8 * D_MODEL // 3 + 255) // 256) * 256
RMS_EPS = 1e-6

kernel_name = "hybrid_pool_shortconv_block"


def _rmsnorm(x, g):
    xf = x.astype(jnp.float32)
    inv = lax.rsqrt(jnp.mean(xf * xf, axis=-1, keepdims=True) + RMS_EPS)
    return (xf * inv).astype(x.dtype) * g


def _trailing_pool_minus_self(u, window):
    seq = u.shape[1]
    uf = u.astype(jnp.float32)
    cs = jnp.cumsum(uf, axis=1)
    cs_lag = jnp.pad(cs, ((0, 0), (window, 0), (0, 0)))[:, :seq]
    cnt = jnp.minimum(jnp.arange(1, seq + 1), window).astype(jnp.float32)
    return ((cs - cs_lag) / cnt[None, :, None] - uf).astype(u.dtype)


def _pool_mixer(v, pool_w, pool_scale):
    b, s, _ = v.shape
    vg = v.reshape(b, s, N_POOL_GROUPS, POOL_GROUP_DIM)
    pooled = jnp.stack(
        [_trailing_pool_minus_self(vg[:, :, i], w) for i, w in enumerate(POOL_WINDOWS)],
        axis=2)
    mixed = jnp.einsum('bsgc,gcd->bsgd', pooled, pool_w)
    return mixed.reshape(b, s, POOL_WIDTH) * pool_scale


def _causal_depthwise_conv(u, conv_w):
    s = u.shape[1]
    up = jnp.pad(u, ((0, 0), (CONV_K - 1, 0), (0, 0)))
    return sum(up[:, k:k + s] * conv_w[k] for k in range(CONV_K))


def _conv_mixer(gb, gc, h, conv_w):
    return gb * _causal_depthwise_conv(gc * h, conv_w)


def setup_inputs(seed: int = 0) -> dict:
    key = jax.random.key(seed)
    ks = jax.random.split(key, 12)
    f32 = jnp.float32
    x = jax.random.normal(ks[0], (BATCH, SEQ, D_MODEL), f32)
    norm1_g = 1.0 + 0.05 * jax.random.normal(ks[1], (D_MODEL,), f32)
    w_in = jax.random.normal(ks[2], (D_MODEL, IN_COLS), f32) * D_MODEL ** -0.5
    pool_w = jax.random.normal(ks[3], (N_POOL_GROUPS, POOL_GROUP_DIM, POOL_GROUP_DIM), f32) * POOL_GROUP_DIM ** -0.5
    pool_scale = 1.0 + 0.05 * jax.random.normal(ks[4], (POOL_WIDTH,), f32)
    conv_w = jax.random.normal(ks[5], (CONV_K, CONV_WIDTH), f32) * CONV_K ** -0.5
    w_out = jax.random.normal(ks[6], (MIX_WIDTH, D_MODEL), f32) * MIX_WIDTH ** -0.5
    norm2_g = 1.0 + 0.05 * jax.random.normal(ks[7], (D_MODEL,), f32)
    w_gate = jax.random.normal(ks[8], (D_MODEL, D_FF), f32) * D_MODEL ** -0.5
    w_up = jax.random.normal(ks[9], (D_MODEL, D_FF), f32) * D_MODEL ** -0.5
    w_down = jax.random.normal(ks[10], (D_FF, D_MODEL), f32) * D_FF ** -0.5
    normf_g = 1.0 + 0.05 * jax.random.normal(ks[11], (D_MODEL,), f32)
    return {"x": x, "norm1_g": norm1_g, "w_in": w_in, "pool_w": pool_w,
            "pool_scale": pool_scale, "conv_w": conv_w, "w_out": w_out,
            "norm2_g": norm2_g, "w_gate": w_gate, "w_up": w_up,
            "w_down": w_down, "normf_g": normf_g}


def reference(x, norm1_g, w_in, pool_w, pool_scale, conv_w, w_out,
              norm2_g, w_gate, w_up, w_down, normf_g):
    for _ in range(DEPTH):
        hn = _rmsnorm(x, norm1_g)
        proj = jnp.einsum('bsd,dc->bsc', hn, w_in)
        v_pool = proj[..., :POOL_WIDTH]
        gb = proj[..., POOL_WIDTH:POOL_WIDTH + CONV_WIDTH]
        gc = proj[..., POOL_WIDTH + CONV_WIDTH:POOL_WIDTH + 2 * CONV_WIDTH]
        h = proj[..., POOL_WIDTH + 2 * CONV_WIDTH:]
        y_pool = _pool_mixer(v_pool, pool_w, pool_scale)
        y_conv = _conv_mixer(gb, gc, h, conv_w)
        y_mix = jnp.concatenate([y_pool, y_conv], axis=-1)
        x = x + jnp.einsum('bsc,cd->bsd', y_mix, w_out)
        hn2 = _rmsnorm(x, norm2_g)
        g = jnp.einsum('bsd,df->bsf', hn2, w_gate)
        u = jnp.einsum('bsd,df->bsf', hn2, w_up)
        x = x + jnp.einsum('bsf,fd->bsd', jax.nn.silu(g) * u, w_down)
    return _rmsnorm(x, normf_g)
```

```cpp
#include <hip/hip_runtime.h>
#include <hip/hip_cooperative_groups.h>
#include <cstdio>
#include <cstdint>
namespace cg = cooperative_groups;
#ifndef MK_N_LAUNCHES
#define MK_N_LAUNCHES 7
#endif
namespace pg8 {
#define PG8_LAS __attribute__((address_space(3)))
typedef unsigned short bf16_t;
typedef short bf16x8 __attribute__((ext_vector_type(8)));
typedef float f32x4 __attribute__((ext_vector_type(4)));
typedef unsigned u32x4 __attribute__((ext_vector_type(4)));
constexpr int BM = 256, BK = 64, HALF = 128, HTB = HALF * BK * 2  , STAGE_BYTES = 8 * HTB, NXCD = 8, WGM = 8;

__host__ __device__ __forceinline__ int lds_byte(int r, int c) { const int st = (r >> 4) * 2 + (c >> 5), rr = r & 15, cc = c & 31, ob = rr * 64 + cc * 2; return st * 1024 + (ob ^ (((ob >> 9) & 1) << 5)); }
__host__ __device__ __forceinline__ void stage_rc(int b, int& R, int& C) { const int st = b / 1024, sb = b % 1024, swz = sb ^ (((sb >> 9) & 1) << 5); R = (st >> 1) * 16 + swz / 64; C = (st & 1) * 32 + (swz % 64) / 2; }
__host__ __device__ __forceinline__ int perm32(int rho) { const int n = rho >> 4, i = rho & 15; return 8 * (i >> 2) + 4 * n + (i & 3); }

struct Unit { int pm, pn; };
struct Gemm { const bf16_t* A; const bf16_t* Bt; int M, N, K; };

struct StaticOrder {
    int nM, nN, nwg, G, c;
    __host__ __device__ void init(int M, int N, int G_, int c_) { nM = M / BM; nN = N / BM; nwg = nM * nN; G = G_; c = c_; }
    __host__ __device__ bool next(int i, Unit& u) const {
        const long L = (long)i * G + c; if (L >= nwg) return false;
        int wgid = (int)L; { const int q = nwg / NXCD, r = nwg % NXCD, xcd = wgid % NXCD, off = wgid / NXCD; wgid = (xcd < r ? xcd * (q + 1) : r * (q + 1) + (xcd - r) * q) + off; }
        const int nig = WGM * nN, gid = wgid / nig, fm = gid * WGM, gsz = (nM - fm) < WGM ? (nM - fm) : WGM;
        u.pm = fm + ((wgid % nig) % gsz); u.pn = (wgid % nig) / gsz; return true;
    }
    __device__ __forceinline__ void a_ready(const Unit&) const {}
    __device__ __forceinline__ void done(const Unit&) const {}
};
__device__ __forceinline__ unsigned cvt_pk_bf16(float lo, float hi) { unsigned r; asm volatile("v_cvt_pk_bf16_f32 %0, %1, %2" : "=v"(r) : "v"(lo), "v"(hi)); return r; }
typedef float f32x2 __attribute__((ext_vector_type(2)));

struct EpiProj {
    static constexpr bool PERM = true, AFTER_DRAIN = false;
    bf16_t* O; int ldc;
    __device__ __forceinline__ void operator()(const f32x4 (&acc)[2][2][4][2], const Unit& u, int wr, int wc, int fr, int fq) const {
        const int row0 = u.pm * BM + wr * 64 + fr, col0 = u.pn * BM + wc * 32 + 8 * fq;
#pragma unroll
        for (int ai = 0; ai < 2; ++ai)
#pragma unroll
            for (int m = 0; m < 4; ++m) { bf16_t* rowp = O + (size_t)(row0 + ai * HALF + m * 16) * ldc + col0;
#pragma unroll
                for (int bj = 0; bj < 2; ++bj) { const f32x4 v0 = acc[ai][bj][m][0], v1 = acc[ai][bj][m][1];
                    u32x4 w; w.x = cvt_pk_bf16(v0[0], v0[1]); w.y = cvt_pk_bf16(v0[2], v0[3]); w.z = cvt_pk_bf16(v1[0], v1[1]); w.w = cvt_pk_bf16(v1[2], v1[3]);
                    *(u32x4*)(rowp + bj * HALF) = w; } }
    }
};
template <bool WB> struct EpiRes {
    static constexpr bool PERM = true, AFTER_DRAIN = false;
    const float* base; float* out; bf16_t* outb; float* ssq; int ldc;
    __device__ __forceinline__ void operator()(const f32x4 (&acc)[2][2][4][2], const Unit& u, int wr, int wc, int fr, int fq) const {
        const int row0 = u.pm * BM + wr * 64 + fr, col0 = u.pn * BM + wc * 32 + 8 * fq;
#pragma unroll
        for (int ai = 0; ai < 2; ++ai)
#pragma unroll
            for (int m = 0; m < 4; ++m) { const int r = row0 + ai * HALF + m * 16; const size_t off = (size_t)r * ldc + col0; float s = 0.f;
#pragma unroll
                for (int bj = 0; bj < 2; ++bj) {
                    const f32x4 b0 = *(const f32x4*)(base + off + bj * HALF), b1 = *(const f32x4*)(base + off + bj * HALF + 4);
                    const f32x4 v0 = b0 + acc[ai][bj][m][0], v1 = b1 + acc[ai][bj][m][1];
                    *(f32x4*)(out + off + bj * HALF) = v0; *(f32x4*)(out + off + bj * HALF + 4) = v1;
                    if (WB) { u32x4 w; w.x = cvt_pk_bf16(v0[0], v0[1]); w.y = cvt_pk_bf16(v0[2], v0[3]); w.z = cvt_pk_bf16(v1[0], v1[1]); w.w = cvt_pk_bf16(v1[2], v1[3]);
                        *(u32x4*)(outb + off + bj * HALF) = w; }
                    s += (v0[0] * v0[0] + v0[1] * v0[1]) + (v0[2] * v0[2] + v0[3] * v0[3]) + (v1[0] * v1[0] + v1[1] * v1[1]) + (v1[2] * v1[2] + v1[3] * v1[3]); }
                s += __shfl_xor(s, 16); s += __shfl_xor(s, 32);
                if (fq == 0) ssq[(size_t)r * 16 + u.pn * 4 + wc] = s;
                asm volatile("" ::: "memory"); }
    }
};
struct EpiSwiglu {
    static constexpr bool PERM = true, AFTER_DRAIN = false;
    bf16_t* O; int ldc; const float* ssq; float inv_d, eps;
    __device__ __forceinline__ void operator()(const f32x4 (&acc)[2][2][4][2], const Unit& u, int wr, int wc, int fr, int fq) const {
        const int row0 = u.pm * BM + wr * 64 + fr, col0 = u.pn * HALF + wc * 32 + 8 * fq;
#pragma unroll
        for (int ai = 0; ai < 2; ++ai)
#pragma unroll
            for (int m = 0; m < 4; ++m) { const int r = row0 + ai * HALF + m * 16;
                const f32x4* sp = (const f32x4*)(ssq + (size_t)r * 16);
                const f32x4 s4 = (sp[0] + sp[1]) + (sp[2] + sp[3]);
                const float inv = __builtin_amdgcn_rsqf(((s4[0] + s4[1]) + (s4[2] + s4[3])) * inv_d + eps);
                float o[8];
#pragma unroll
                for (int n = 0; n < 2; ++n)
#pragma unroll
                    for (int j = 0; j < 4; ++j) { const float g = acc[ai][0][m][n][j] * inv, up = acc[ai][1][m][n][j] * inv;
                        const float e = __builtin_amdgcn_exp2f(g * -1.44269504089f);
                        o[n * 4 + j] = g * __builtin_amdgcn_rcpf(1.0f + e) * up; }
                u32x4 w; w.x = cvt_pk_bf16(o[0], o[1]); w.y = cvt_pk_bf16(o[2], o[3]); w.z = cvt_pk_bf16(o[4], o[5]); w.w = cvt_pk_bf16(o[6], o[7]);
                *(u32x4*)(O + (size_t)r * ldc + col0) = w; }
    }
};

template <class Epi, class Sched, bool ALIGN_EPI = false, bool SP2 = false>
__device__ __forceinline__ void gemm_phase(PG8_LAS unsigned char* lds, const Gemm g, const Sched& S, const Epi& E) {
    const int tid = threadIdx.x, wid = __builtin_amdgcn_readfirstlane(tid >> 6), lane = tid & 63, wr = wid >> 2, wc = wid & 3, fr = lane & 15, fq = lane >> 4;
    const int K = g.K, nt = K / BK;
    unsigned voffA[2], voffB[2];
#pragma unroll
    for (int i = 0; i < 2; ++i) { int R, C; stage_rc(tid * 16 + i * 8192, R, C); const int Rb = Epi::PERM ? ((R & ~31) + perm32(R & 31)) : R;
        voffA[i] = (unsigned)(R * K + C) * 2u; voffB[i] = (unsigned)(Rb * K + C) * 2u; }
    const size_t kstep = (size_t)(BK * 2);
    const size_t hstep = (size_t)HALF * K * 2;
    const size_t tstep = 2 * hstep;
    const unsigned ldsw = (unsigned)wid * 1024u;
    const int aoff = lds_byte(wr * 64 + fr, fq * 8), boff = lds_byte(wc * 32 + fr, fq * 8);
#define PG8_SA(b, h) (((b) * 2 + (h)) * HTB)
#define PG8_SB(b, h) ((4 + (b) * 2 + (h)) * HTB)
#define PG8_STAGE(bufoff, gbase, voff) do { _Pragma("unroll") for (int _i = 0; _i < 2; ++_i) \
        __builtin_amdgcn_global_load_lds((const unsigned*)((const char*)(gbase) + (voff)[_i]), (PG8_LAS unsigned*)(lds + (bufoff) + ldsw + _i * 8192), 16, 0, 0); } while (0)
#define PG8_LDA(dst, b, h) do { _Pragma("unroll") for (int m = 0; m < 4; ++m) _Pragma("unroll") for (int k = 0; k < 2; ++k) dst[m][k] = *(const PG8_LAS bf16x8*)(lds + PG8_SA(b, h) + aoff + m * 2048 + k * 1024); } while (0)
#define PG8_LDB(dst, b, h) do { _Pragma("unroll") for (int n = 0; n < 2; ++n) _Pragma("unroll") for (int k = 0; k < 2; ++k) dst[n][k] = *(const PG8_LAS bf16x8*)(lds + PG8_SB(b, h) + boff + n * 2048 + k * 1024); } while (0)
#define PG8_MMA(ai, bj, At, Bt) do { __builtin_amdgcn_s_setprio(1); _Pragma("unroll") for (int m = 0; m < 4; ++m) _Pragma("unroll") for (int n = 0; n < 2; ++n) _Pragma("unroll") for (int k = 0; k < 2; ++k) \
        acc[ai][bj][m][n] = __builtin_amdgcn_mfma_f32_16x16x32_bf16(Bt[n][k], At[m][k], acc[ai][bj][m][n], 0, 0, 0); __builtin_amdgcn_s_setprio(0); } while (0)
#define PG8_WAIT_V(n) asm volatile("s_waitcnt vmcnt(" #n ")" ::: "memory")
#define PG8_WAIT_L(n) asm volatile("s_waitcnt lgkmcnt(" #n ")" ::: "memory")
#define PG8_BAR __builtin_amdgcn_s_barrier()
#define PG8_SCHED __builtin_amdgcn_sched_barrier(0)
    Unit cur, nxt; int ui = 0;
    if (!S.next(0, cur)) return;
    f32x4 acc[2][2][4][2];
#pragma unroll
    for (int a = 0; a < 2; ++a)
#pragma unroll
        for (int b = 0; b < 2; ++b)
#pragma unroll
            for (int m = 0; m < 4; ++m)
#pragma unroll
                for (int n = 0; n < 2; ++n) acc[a][b][m][n] = (f32x4){0.f, 0.f, 0.f, 0.f};
    bf16x8 At[4][2], B0[2][2], B1[2][2];
    const char* cA = (const char*)g.A + (size_t)cur.pm * tstep; const char* cB = (const char*)g.Bt + (size_t)cur.pn * tstep;
    S.a_ready(cur);
    if constexpr (SP2) {
        PG8_STAGE(PG8_SB(0, 0), cB, voffB); PG8_STAGE(PG8_SB(0, 1), cB + hstep, voffB); PG8_STAGE(PG8_SA(0, 0), cA, voffA); PG8_STAGE(PG8_SA(0, 1), cA + hstep, voffA);
        if (wr == 1) PG8_BAR;
        PG8_WAIT_V(2); PG8_BAR;
        PG8_STAGE(PG8_SB(1, 0), cB + kstep, voffB); PG8_STAGE(PG8_SA(1, 0), cA + kstep, voffA); PG8_STAGE(PG8_SB(1, 1), cB + hstep + kstep, voffB);
        PG8_WAIT_V(6); PG8_BAR;
    } else {
        PG8_STAGE(PG8_SB(0, 0), cB, voffB); PG8_STAGE(PG8_SA(0, 0), cA, voffA); PG8_STAGE(PG8_SB(0, 1), cB + hstep, voffB); PG8_STAGE(PG8_SA(0, 1), cA + hstep, voffA);
        if (wr == 1) PG8_BAR;
        PG8_WAIT_V(4); PG8_BAR;
        PG8_STAGE(PG8_SB(1, 0), cB + kstep, voffB); PG8_STAGE(PG8_SA(1, 0), cA + kstep, voffA); PG8_STAGE(PG8_SB(1, 1), cB + hstep + kstep, voffB);
        PG8_WAIT_V(6); PG8_BAR;
    }
    for (;;) {
        const bool has_next = S.next(ui + 1, nxt);
        const char* nA = has_next ? (const char*)g.A + (size_t)nxt.pm * tstep : cA; const char* nB = has_next ? (const char*)g.Bt + (size_t)nxt.pn * tstep : cB;
        for (int t = 0; t < nt; t += 2) {
            const bool last = (t == nt - 2);
            const char* a1 = cA + (size_t)(t + 1) * kstep;
            const char* a2 = last ? nA : cA + (size_t)(t + 2) * kstep; const char* b2 = last ? nB : cB + (size_t)(t + 2) * kstep;
            const char* a3 = a2 + kstep; const char* b3 = b2 + kstep;
            if (last && has_next) S.a_ready(nxt);
            if constexpr (SP2) {
            PG8_LDB(B0, 0, 0); PG8_LDB(B1, 0, 1); PG8_SCHED; PG8_LDA(At, 0, 0); PG8_STAGE(PG8_SA(1, 1), a1 + hstep, voffA);
            PG8_WAIT_V(8); PG8_WAIT_L(0); PG8_BAR; PG8_MMA(0, 0, At, B0); PG8_MMA(0, 1, At, B1); PG8_BAR; PG8_SCHED;
            PG8_LDA(At, 0, 1); PG8_STAGE(PG8_SB(0, 0), b2, voffB); PG8_STAGE(PG8_SB(0, 1), b2 + hstep, voffB); PG8_STAGE(PG8_SA(0, 0), a2, voffA);
            PG8_WAIT_V(8); PG8_WAIT_L(0); PG8_BAR; PG8_MMA(1, 0, At, B0); PG8_MMA(1, 1, At, B1); PG8_BAR; PG8_SCHED;
            PG8_LDB(B0, 1, 0); PG8_LDB(B1, 1, 1); PG8_SCHED; PG8_LDA(At, 1, 0); PG8_STAGE(PG8_SA(0, 1), a2 + hstep, voffA);
            PG8_WAIT_V(8); PG8_WAIT_L(0); PG8_BAR; PG8_MMA(0, 0, At, B0); PG8_MMA(0, 1, At, B1); PG8_BAR; PG8_SCHED;
            PG8_LDA(At, 1, 1); PG8_STAGE(PG8_SB(1, 0), b3, voffB); PG8_STAGE(PG8_SB(1, 1), b3 + hstep, voffB); PG8_STAGE(PG8_SA(1, 0), a3, voffA);
            PG8_WAIT_V(8); PG8_WAIT_L(0); PG8_BAR; PG8_MMA(1, 0, At, B0); PG8_MMA(1, 1, At, B1); PG8_BAR; PG8_SCHED;
            } else {
            PG8_LDB(B0, 0, 0); PG8_SCHED; PG8_LDA(At, 0, 0); PG8_STAGE(PG8_SA(1, 1), a1 + hstep, voffA);
            PG8_WAIT_L(8); PG8_BAR; PG8_WAIT_L(0); PG8_MMA(0, 0, At, B0); PG8_BAR; PG8_SCHED;
            PG8_LDB(B1, 0, 1); PG8_STAGE(PG8_SB(0, 0), b2, voffB);
            PG8_BAR; PG8_WAIT_L(0); PG8_MMA(0, 1, At, B1); PG8_BAR;
            PG8_LDA(At, 0, 1); PG8_STAGE(PG8_SA(0, 0), a2, voffA);
            PG8_BAR; PG8_WAIT_L(0); PG8_MMA(1, 0, At, B0); PG8_BAR; PG8_SCHED;
            PG8_STAGE(PG8_SB(0, 1), b2 + hstep, voffB);
            PG8_WAIT_V(6); PG8_BAR; PG8_MMA(1, 1, At, B1); PG8_BAR;
            PG8_LDB(B0, 1, 0); PG8_SCHED; PG8_LDA(At, 1, 0); PG8_STAGE(PG8_SA(0, 1), a2 + hstep, voffA);
            PG8_WAIT_L(8); PG8_BAR; PG8_WAIT_L(0); PG8_MMA(0, 0, At, B0); PG8_BAR; PG8_SCHED;
            PG8_LDB(B1, 1, 1); PG8_STAGE(PG8_SB(1, 0), b3, voffB);
            PG8_BAR; PG8_WAIT_L(0); PG8_MMA(0, 1, At, B1); PG8_BAR;
            PG8_LDA(At, 1, 1); PG8_STAGE(PG8_SA(1, 0), a3, voffA);
            PG8_BAR; PG8_WAIT_L(0); PG8_MMA(1, 0, At, B0); PG8_BAR; PG8_SCHED;
            PG8_STAGE(PG8_SB(1, 1), b3 + hstep, voffB);
            PG8_WAIT_V(6); PG8_BAR; PG8_MMA(1, 1, At, B1); PG8_BAR;
            }
        }
        if constexpr (ALIGN_EPI) { if (wr == 0) PG8_BAR; }
        if constexpr (!Epi::AFTER_DRAIN) { E(acc, cur, wr, wc, fr, fq); S.done(cur); }
        if (!has_next) break;
#pragma unroll
        for (int a = 0; a < 2; ++a)
#pragma unroll
            for (int b = 0; b < 2; ++b)
#pragma unroll
                for (int m = 0; m < 4; ++m)
#pragma unroll
                    for (int n = 0; n < 2; ++n) acc[a][b][m][n] = (f32x4){0.f, 0.f, 0.f, 0.f};
        cur = nxt; cA = nA; cB = nB; ++ui;
        if constexpr (ALIGN_EPI) { if (wr == 1) PG8_BAR; }
    }
    PG8_WAIT_V(0);
    if constexpr (!ALIGN_EPI) { if (wr == 0) PG8_BAR; }
    PG8_BAR;
    if constexpr (Epi::AFTER_DRAIN) { E.fused(acc, cur, wr, wc, fr, fq, lds, wid, lane); S.done(cur); }
#undef PG8_SA
#undef PG8_SB
#undef PG8_STAGE
#undef PG8_LDA
#undef PG8_LDB
#undef PG8_MMA
#undef PG8_WAIT_V
#undef PG8_WAIT_L
#undef PG8_BAR
#undef PG8_SCHED
}
}

#ifndef PG8_SP2
#define PG8_SP2 true
#endif
#ifndef PG8_ALIGN
#define PG8_ALIGN true
#endif
constexpr int NWAVES = 8;
constexpr int N_LAUNCHES = MK_N_LAUNCHES;
constexpr int N_PHASES = 7;
constexpr int BATCH = 2, SEQ = 8192, D = 1024, M = BATCH * SEQ;
constexpr int POOLW = 512, CONVW = 512, INC = 2048, FF = 2816, N3 = 2 * FF;
constexpr float RMS_EPS = 1e-6f;
constexpr size_t MiB = 1u << 20;
constexpr size_t WS_W1 = 2 * MiB;
constexpr size_t WS_W2 = 6 * MiB;
constexpr size_t WS_W3 = 8 * MiB;
constexpr size_t WS_W4 = 19 * MiB;
constexpr size_t WS_SSQ2 = 25 * MiB;
constexpr size_t WS_SSQF = 26 * MiB;
constexpr size_t WS_HN = 32 * MiB;
constexpr size_t WS_PROJ = 64 * MiB;
constexpr size_t WS_A2 = 128 * MiB;
constexpr size_t WS_ACT = 64 * MiB;
constexpr size_t WS_X1 = 160 * MiB;
constexpr size_t WS_END = 224 * MiB;
static_assert(WS_ACT + (size_t)M * FF * 2 <= WS_X1 && WS_W4 + (size_t)D * FF * 2 <= WS_SSQ2 && WS_W3 + (size_t)N3 * D * 2 <= WS_W4, "d_ws map");
constexpr int RING_BYTES = 131072;
constexpr int LDS_BYTES = 147456;

#define GAS __attribute__((address_space(1)))
#define LAS __attribute__((address_space(3)))
typedef unsigned short bf16;
typedef unsigned v4u __attribute__((ext_vector_type(4)));
typedef float f32x4 __attribute__((ext_vector_type(4)));
#define LDS_WAIT() asm volatile("s_waitcnt lgkmcnt(0)" ::: "memory")
__device__ __forceinline__ unsigned f2bf(float f) { unsigned u = __builtin_bit_cast(unsigned, f); return (u + 0x7fffu + ((u >> 16) & 1u)) >> 16; }
__device__ __forceinline__ unsigned pk2(float lo, float hi) { return f2bf(lo) | (f2bf(hi) << 16); }
__device__ __forceinline__ float bflo(unsigned w) { return __builtin_bit_cast(float, w << 16); }
__device__ __forceinline__ float bfhi(unsigned w) { return __builtin_bit_cast(float, w & 0xffff0000u); }
__device__ __forceinline__ void unpack8(const v4u w, float (&f)[8]) { f[0] = bflo(w.x); f[1] = bfhi(w.x); f[2] = bflo(w.y); f[3] = bfhi(w.y); f[4] = bflo(w.z); f[5] = bfhi(w.z); f[6] = bflo(w.w); f[7] = bfhi(w.w); }
__device__ __forceinline__ float wave_sum(float v) {
#pragma unroll
    for (int o = 1; o < 64; o <<= 1) v += __shfl_xor(v, o);
    return v;
}

__device__ __forceinline__ void p0_writeout(bf16* WT, int ldt, int k0, int nd0, LAS float* scr, int lane) {
    LDS_WAIT(); asm volatile("" ::: "memory");
    const int c = lane & 7;
#pragma unroll
    for (int j = 0; j < 4; ++j) { const int n = (lane >> 3) + 8 * j; const LAS float* s = scr + (8 * c) * 33 + n;
        v4u o; o.x = pk2(s[0 * 33], s[1 * 33]); o.y = pk2(s[2 * 33], s[3 * 33]); o.z = pk2(s[4 * 33], s[5 * 33]); o.w = pk2(s[6 * 33], s[7 * 33]);
        *(v4u*)(WT + (size_t)(nd0 + n) * ldt + k0 + 8 * c) = o; }
    LDS_WAIT(); asm volatile("" ::: "memory");
}
__device__ __forceinline__ void p0_item_T(const float* W, int ldw, const float* ksc, bf16* WT, int ldt, int k0, int ns0, int nd0, LAS float* scr, int lane) {
#pragma unroll 8
    for (int i = 0; i < 32; ++i) { const int kk = 2 * i + (lane >> 5); float v = W[(size_t)(k0 + kk) * ldw + ns0 + (lane & 31)]; if (ksc) v *= ksc[k0 + kk]; scr[kk * 33 + (lane & 31)] = v; }
    p0_writeout(WT, ldt, k0, nd0, scr, lane);
}
__device__ __forceinline__ void p0_item_weff(const float* pool_w, const float* pool_scale, const float* w_out, bf16* W2t, int item, LAS float* scr, int lane) {
    const int kb = item >> 5, nb = item & 31, k0 = 64 * kb, n0 = 32 * nb, g = k0 >> 7;
    const float* pwrow = pool_w + (size_t)(k0 + lane) * 128;
    const float* sc = pool_scale + g * 128;
    const float* wo = w_out + (size_t)(g * 128) * D + n0;
    float acc[32];
#pragma unroll
    for (int n = 0; n < 32; ++n) acc[n] = 0.f;
    for (int j4 = 0; j4 < 32; ++j4) {
        f32x4 p = *(const f32x4*)(pwrow + 4 * j4); const f32x4 s4 = *(const f32x4*)(sc + 4 * j4); p = p * s4;
#pragma unroll
        for (int jj = 0; jj < 4; ++jj) { const float* wrow = wo + (size_t)(4 * j4 + jj) * D;
#pragma unroll
            for (int n = 0; n < 32; ++n) acc[n] += p[jj] * wrow[n]; }
    }
#pragma unroll
    for (int n = 0; n < 32; ++n) scr[lane * 33 + n] = acc[n];
    p0_writeout(W2t, D, k0, n0, scr, lane);
}
__device__ __forceinline__ void rms_row_to_bf16(const float* xrow, const float* gvec, bf16* orow, int lane) {
    const f32x4* xr = (const f32x4*)xrow + lane; const f32x4* gr = (const f32x4*)gvec + lane;
    f32x4 v[4]; float s = 0.f;
#pragma unroll
    for (int j = 0; j < 4; ++j) { v[j] = xr[64 * j]; s += (v[j].x * v[j].x + v[j].y * v[j].y) + (v[j].z * v[j].z + v[j].w * v[j].w); }
    const float inv = 1.0f / sqrtf(wave_sum(s) * (1.f / D) + RMS_EPS);
    unsigned long long* o8 = (unsigned long long*)orow + lane;
#pragma unroll
    for (int j = 0; j < 4; ++j) { const f32x4 gg = gr[64 * j]; const f32x4 t = (v[j] * inv) * gg;
        o8[64 * j] = (unsigned long long)pk2(t.x, t.y) | ((unsigned long long)pk2(t.z, t.w) << 32); }
}
struct Ptrs {
    const float *x, *g1, *w_in, *pool_w, *pool_scale, *conv_w, *w_out, *g2, *w_gate, *w_up, *w_down, *gf;
    float* out; unsigned char* ws;
};
__device__ __forceinline__ void p0_prologue(const Ptrs& P, LAS unsigned char* lds, int wave, int lane, int G) {
    LAS float* scr = (LAS float*)(lds + wave * 16384);
    const int gw = wave * G + (int)blockIdx.x, NGW = G * NWAVES;
    bf16* W1t = (bf16*)(P.ws + WS_W1); bf16* W2t = (bf16*)(P.ws + WS_W2); bf16* W3t = (bf16*)(P.ws + WS_W3); bf16* W4t = (bf16*)(P.ws + WS_W4);
    constexpr int I_E = 8 * 32;
    constexpr int I_1 = (D / 64) * (INC / 32);
    constexpr int I_2 = 8 * 32;
    constexpr int I_3 = (D / 64) * (FF / 32);
    constexpr int I_4 = (FF / 64) * (D / 32);
    constexpr int NITEMS = I_E + I_1 + I_2 + 2 * I_3 + I_4;
    for (int it = gw; it < NITEMS; it += NGW) {
        int r = it;
        if (r < I_E) { p0_item_weff(P.pool_w, P.pool_scale, P.w_out, W2t, r, scr, lane); continue; } r -= I_E;
        if (r < I_1) { const int nblk = INC / 32, kb = r / nblk, nb = r % nblk; p0_item_T(P.w_in, INC, nullptr, W1t, D, 64 * kb, 32 * nb, 32 * nb, scr, lane); continue; } r -= I_1;
        if (r < I_2) { const int kb = 8 + (r >> 5), nb = r & 31; p0_item_T(P.w_out, D, nullptr, W2t, D, 64 * kb, 32 * nb, 32 * nb, scr, lane); continue; } r -= I_2;
        if (r < 2 * I_3) { const int half = r >= I_3; if (half) r -= I_3; const int nblk = FF / 32, kb = r / nblk, nb = r % nblk, f0 = 32 * nb;
            p0_item_T(half ? P.w_up : P.w_gate, FF, P.g2, W3t, D, 64 * kb, f0, 256 * (f0 >> 7) + 128 * half + (f0 & 127), scr, lane); continue; } r -= 2 * I_3;
        { const int nblk = D / 32, kb = r / nblk, nb = r % nblk; p0_item_T(P.w_down, D, nullptr, W4t, FF, 64 * kb, 32 * nb, 32 * nb, scr, lane); }
    }
    bf16* HN = (bf16*)(P.ws + WS_HN);
    for (int m = gw; m < M; m += NGW) rms_row_to_bf16(P.x + (size_t)m * D, P.g1, HN + (size_t)m * D, lane);
}

__device__ __forceinline__ void p2_mixers(const Ptrs& P, int tid, int G) {
    const bf16* PR = (const bf16*)(P.ws + WS_PROJ); bf16* A2 = (bf16*)(P.ws + WS_A2);
    const int chunk = tid & 127, sub = tid >> 7;
    for (int strip = (int)blockIdx.x * 4 + sub; strip < M / 16; strip += G * 4) {
        const int t0 = strip * 16, s0 = t0 & (SEQ - 1);
        if (chunk < 64) {
            const int c8 = chunk * 8, w = 2 << (chunk >> 4);
            float S[8];
#pragma unroll
            for (int i = 0; i < 8; ++i) S[i] = 0.f;
            for (int j = 1; j < 16; ++j) if (j < w && s0 - j >= 0) { float f[8]; unpack8(*(const v4u*)(PR + (size_t)(t0 - j) * INC + c8), f);
#pragma unroll
                for (int i = 0; i < 8; ++i) S[i] += f[i]; }
#pragma unroll 4
            for (int i = 0; i < 16; ++i) { const int t = t0 + i, s = s0 + i;
                float f[8]; unpack8(*(const v4u*)(PR + (size_t)t * INC + c8), f);
                const int cnt = (s + 1 < w) ? s + 1 : w; const float rc = 1.0f / (float)cnt; float o[8];
#pragma unroll
                for (int q = 0; q < 8; ++q) { S[q] += f[q]; o[q] = S[q] * rc - f[q]; }
                v4u ov; ov.x = pk2(o[0], o[1]); ov.y = pk2(o[2], o[3]); ov.z = pk2(o[4], o[5]); ov.w = pk2(o[6], o[7]);
                *(v4u*)(A2 + (size_t)t * D + c8) = ov;
                if (s - w + 1 >= 0) { float e[8]; unpack8(*(const v4u*)(PR + (size_t)(t - w + 1) * INC + c8), e);
#pragma unroll
                    for (int q = 0; q < 8; ++q) S[q] -= e[q]; } }
        } else {
            const int cc = (chunk - 64) * 8;
            float w0[8], w1[8], w2[8], u1[8], u2[8];
#pragma unroll
            for (int q = 0; q < 8; ++q) { w0[q] = P.conv_w[cc + q]; w1[q] = P.conv_w[CONVW + cc + q]; w2[q] = P.conv_w[2 * CONVW + cc + q]; u1[q] = 0.f; u2[q] = 0.f; }
            if (s0 > 0) { float a[8], b[8];
                unpack8(*(const v4u*)(PR + (size_t)(t0 - 2) * INC + 1024 + cc), a); unpack8(*(const v4u*)(PR + (size_t)(t0 - 2) * INC + 1536 + cc), b);
#pragma unroll
                for (int q = 0; q < 8; ++q) u2[q] = a[q] * b[q];
                unpack8(*(const v4u*)(PR + (size_t)(t0 - 1) * INC + 1024 + cc), a); unpack8(*(const v4u*)(PR + (size_t)(t0 - 1) * INC + 1536 + cc), b);
#pragma unroll
                for (int q = 0; q < 8; ++q) u1[q] = a[q] * b[q]; }
#pragma unroll 4
            for (int i = 0; i < 16; ++i) { const int t = t0 + i; const bf16* row = PR + (size_t)t * INC + cc;
                float gb[8], gc[8], hh[8], o[8]; unpack8(*(const v4u*)(row + 512), gb); unpack8(*(const v4u*)(row + 1024), gc); unpack8(*(const v4u*)(row + 1536), hh);
#pragma unroll
                for (int q = 0; q < 8; ++q) { const float u0 = gc[q] * hh[q]; o[q] = gb[q] * ((u2[q] * w0[q] + u1[q] * w1[q]) + u0 * w2[q]); u2[q] = u1[q]; u1[q] = u0; }
                v4u ov; ov.x = pk2(o[0], o[1]); ov.y = pk2(o[2], o[3]); ov.z = pk2(o[4], o[5]); ov.w = pk2(o[6], o[7]);
                *(v4u*)(A2 + (size_t)t * D + 512 + cc) = ov; }
        }
    }
}

__device__ __forceinline__ void p6_final_norm(const Ptrs& P, int wave, int lane, int G) {
    const int gw = (int)blockIdx.x * NWAVES + wave, NGW = G * NWAVES;
    const float* ssq = (const float*)(P.ws + WS_SSQF);
    for (int m = gw; m < M; m += NGW) {
        const f32x4* sp = (const f32x4*)(ssq + (size_t)m * 16);
        const f32x4 s4 = (sp[0] + sp[1]) + (sp[2] + sp[3]);
        const float inv = 1.0f / sqrtf(((s4[0] + s4[1]) + (s4[2] + s4[3])) * (1.f / D) + RMS_EPS);
        f32x4* xr = (f32x4*)(P.out + (size_t)m * D) + lane; const f32x4* gr = (const f32x4*)P.gf + lane;
#pragma unroll
        for (int j = 0; j < 4; ++j) { const f32x4 v = xr[64 * j]; xr[64 * j] = (v * inv) * gr[64 * j]; }
    }
}

struct Args { Ptrs p; int ph_lo, ph_hi; };
__global__ void __launch_bounds__(NWAVES * 64, 2) hybrid_fwd(Args args) {
    extern __shared__ __attribute__((aligned(16))) unsigned char lds_raw[];
    LAS unsigned char* lds = (LAS unsigned char*)lds_raw;
    const Ptrs& P = args.p;
    const int tid = threadIdx.x, lane = tid & 63, wave = __builtin_amdgcn_readfirstlane(tid >> 6), G = gridDim.x;
    const int lo = args.ph_lo, hi = args.ph_hi;
#define IN(k) (lo <= (k) && (k) < hi)
#define SEAM(k) do { if constexpr (N_LAUNCHES == 1) { if (IN(k) && IN((k) + 1)) cg::this_grid().sync(); } } while (0)
    unsigned char* ws = P.ws;
    const pg8::bf16_t* W1t = (const pg8::bf16_t*)(ws + WS_W1); const pg8::bf16_t* W2t = (const pg8::bf16_t*)(ws + WS_W2);
    const pg8::bf16_t* W3t = (const pg8::bf16_t*)(ws + WS_W3); const pg8::bf16_t* W4t = (const pg8::bf16_t*)(ws + WS_W4);
    pg8::bf16_t* HN = (pg8::bf16_t*)(ws + WS_HN); pg8::bf16_t* PROJ = (pg8::bf16_t*)(ws + WS_PROJ); pg8::bf16_t* A2 = (pg8::bf16_t*)(ws + WS_A2);
    pg8::bf16_t* ACT = (pg8::bf16_t*)(ws + WS_ACT); float* X1 = (float*)(ws + WS_X1); float* SSQ2 = (float*)(ws + WS_SSQ2); float* SSQF = (float*)(ws + WS_SSQF);

    if (IN(0)) { p0_prologue(P, lds, wave, lane, G); }
    SEAM(0);
    if (IN(1)) {
        pg8::Gemm g{HN, W1t, M, INC, D}; pg8::StaticOrder S; S.init(M, INC, G, (int)blockIdx.x);
        pg8::EpiProj E{PROJ, INC};
        pg8::gemm_phase<pg8::EpiProj, pg8::StaticOrder, PG8_ALIGN, PG8_SP2>(lds, g, S, E);
    }
    SEAM(1);
    if (IN(2)) { p2_mixers(P, tid, G); }
    SEAM(2);
    if (IN(3)) {
        pg8::Gemm g{A2, W2t, M, D, D}; pg8::StaticOrder S; S.init(M, D, G, (int)blockIdx.x);
        pg8::EpiRes<true> E{P.x, X1, HN, SSQ2, D};
        pg8::gemm_phase<pg8::EpiRes<true>, pg8::StaticOrder, false, PG8_SP2>(lds, g, S, E);
    }
    SEAM(3);
    if (IN(4)) {
        pg8::Gemm g{HN, W3t, M, N3, D}; pg8::StaticOrder S; S.init(M, N3, G, (int)blockIdx.x);
        pg8::EpiSwiglu E{ACT, FF, SSQ2, 1.0f / D, RMS_EPS};
        pg8::gemm_phase<pg8::EpiSwiglu, pg8::StaticOrder, PG8_ALIGN, PG8_SP2>(lds, g, S, E);
    }
    SEAM(4);
    if (IN(5)) {
        pg8::Gemm g{ACT, W4t, M, D, FF}; pg8::StaticOrder S; S.init(M, D, G, (int)blockIdx.x);
        pg8::EpiRes<false> E{X1, P.out, nullptr, SSQF, D};
        pg8::gemm_phase<pg8::EpiRes<false>, pg8::StaticOrder, false, PG8_SP2>(lds, g, S, E);
    }
    SEAM(5);
    if (IN(6)) { p6_final_norm(P, wave, lane, G); }
#undef IN
#undef SEAM
}

extern "C" void kernel_launch(void* const* d_in, const int* in_sizes, int n_in, void* d_out, int out_size, void* d_ws, size_t ws_size, hipStream_t stream) {
    static int grid = 0;
    if (grid == 0) {
        if (n_in != 12 || in_sizes[0] != M * D || out_size != M * D || ws_size < WS_END) { fprintf(stderr, "kernel_launch: unexpected shapes (n_in %d, in0 %d, out %d, ws %zu); nothing launched\n", n_in, n_in > 0 ? in_sizes[0] : -1, out_size, ws_size); grid = -1; return; }
        int dev = 0, cus = 0, per_cu = 0;
        if (hipGetDevice(&dev) != hipSuccess || hipDeviceGetAttribute(&cus, hipDeviceAttributeMultiprocessorCount, dev) != hipSuccess) { fprintf(stderr, "kernel_launch: device query failed\n"); grid = -1; return; }
        if (hipFuncSetAttribute((const void*)hybrid_fwd, hipFuncAttributeMaxDynamicSharedMemorySize, LDS_BYTES) != hipSuccess) { fprintf(stderr, "kernel_launch: hipFuncSetAttribute failed\n"); grid = -1; return; }
        if (hipOccupancyMaxActiveBlocksPerMultiprocessor(&per_cu, (const void*)hybrid_fwd, NWAVES * 64, LDS_BYTES) != hipSuccess || per_cu < 1) { fprintf(stderr, "kernel_launch: occupancy query reports %d blocks per CU; using 1\n", per_cu); per_cu = 1; }
        (void)hipGetLastError();
        grid = cus * per_cu;
        fprintf(stderr, "kernel_launch: grid %d (%d CUs x %d)\n", grid, cus, per_cu);
    }
    if (grid < 0) return;
    Args a{};
    a.p.x = (const float*)d_in[0]; a.p.g1 = (const float*)d_in[1]; a.p.w_in = (const float*)d_in[2]; a.p.pool_w = (const float*)d_in[3]; a.p.pool_scale = (const float*)d_in[4];
    a.p.conv_w = (const float*)d_in[5]; a.p.w_out = (const float*)d_in[6]; a.p.g2 = (const float*)d_in[7]; a.p.w_gate = (const float*)d_in[8]; a.p.w_up = (const float*)d_in[9];
    a.p.w_down = (const float*)d_in[10]; a.p.gf = (const float*)d_in[11]; a.p.out = (float*)d_out; a.p.ws = (unsigned char*)d_ws;
    if (N_LAUNCHES == 1) {
        a.ph_lo = 0; a.ph_hi = N_PHASES;
        void* kargs[] = {&a};
        const hipError_t le = hipLaunchCooperativeKernel((const void*)hybrid_fwd, dim3(grid), dim3(NWAVES * 64), kargs, LDS_BYTES, stream);
        if (le != hipSuccess) fprintf(stderr, "kernel_launch: cooperative launch failed: %s (grid %d)\n", hipGetErrorString(le), grid);
    } else {
        for (int p = 0; p < N_PHASES; ++p) {
            a.ph_lo = p; a.ph_hi = p + 1;
            hipLaunchKernelGGL(hybrid_fwd, dim3(grid), dim3(NWAVES * 64), LDS_BYTES, stream, a);
            const hipError_t le = hipPeekAtLastError();
            if (le != hipSuccess) { fprintf(stderr, "kernel_launch: launch %d failed: %s\n", p, hipGetErrorName(le)); break; }
        }
    }
}
```
